# Optimizing an MI355X kernel written in HIP

```python
import math
import jax, jax.numpy as jnp
from jax import lax
import numpy as np

D_MODEL = 1024
BATCH = 4
SEQ = 4096
DEPTH = 2

D_MIX = D_MODEL
D_GROUP = D_MIX // 4
CONV_WIDTH = 31
N_DIFF_HEADS = 4
DIFF_QK_DIM = D_GROUP // N_DIFF_HEADS // 2
DIFF_V_DIM = 2 * DIFF_QK_DIM
N_SG_HEADS = 4
SG_HEAD_DIM = D_GROUP // N_SG_HEADS
CHUNK = 128
POOL_WINDOWS = (2, 4, 8, 16)
N_POOL_GROUPS = len(POOL_WINDOWS)
POOL_GROUP_DIM = D_GROUP // N_POOL_GROUPS
D_FF = 4 * D_MODEL
N_BUCKETS = 32
MAX_DISTANCE = 128
Q_BLOCK = 128
LN_EPS = 1e-5
DEEPNORM_ALPHA = (2.0 * DEPTH) ** 0.25
DEEPNORM_BETA = (8.0 * DEPTH) ** -0.25

SPLIT_SIZES = (2 * D_GROUP,
               N_DIFF_HEADS * DIFF_QK_DIM, N_DIFF_HEADS * DIFF_QK_DIM,
               N_DIFF_HEADS * DIFF_QK_DIM, N_DIFF_HEADS * DIFF_QK_DIM,
               N_DIFF_HEADS * DIFF_V_DIM,
               D_GROUP, D_GROUP,
               D_GROUP)
D_IN = sum(SPLIT_SIZES)
SPLIT_OFFSETS = tuple(int(o) for o in np.cumsum((0,) + SPLIT_SIZES))

kernel_name = "hybrid_conv_diffattn_sgmlp_pool_deepnorm"


def layer_norm(x, g, b):
    xf = x.astype(jnp.float32)
    mu = jnp.mean(xf, axis=-1, keepdims=True)
    var = jnp.mean(jnp.square(xf - mu), axis=-1, keepdims=True)
    y = (xf - mu) * lax.rsqrt(var + LN_EPS) * g.astype(jnp.float32) + b.astype(jnp.float32)
    return y.astype(x.dtype)


def rms_norm(x, g):
    xf = x.astype(jnp.float32)
    y = xf * lax.rsqrt(jnp.mean(jnp.square(xf), axis=-1, keepdims=True) + LN_EPS) * g.astype(jnp.float32)
    return y.astype(x.dtype)


def t5_bucket(q_pos, k_pos):
    n = jnp.maximum(q_pos[:, None] - k_pos[None, :], 0)
    max_exact = N_BUCKETS // 2
    large = max_exact + (jnp.log(jnp.maximum(n, 1).astype(jnp.float32) / max_exact)
                         / math.log(MAX_DISTANCE / max_exact) * (N_BUCKETS - max_exact)).astype(jnp.int32)
    large = jnp.minimum(large, N_BUCKETS - 1)
    return jnp.where(n < max_exact, n, large)


def conformer_conv(a, gate, conv_w, conv_b, ln_g, ln_b, pw_w, pw_b):
    h = a * jax.nn.sigmoid(gate)
    h = lax.conv_general_dilated(h, conv_w[:, None, :].astype(h.dtype), window_strides=(1,),
                                 padding=[(CONV_WIDTH - 1, 0)],
                                 dimension_numbers=('NWC', 'WIO', 'NWC'),
                                 feature_group_count=D_GROUP) + conv_b
    h = jax.nn.silu(layer_norm(h, ln_g, ln_b))
    return h @ pw_w + pw_b


def diff_attention(q1, q2, k1, k2, v, lam, lam_init, rel_bias, norm_g):
    B, S = q1.shape[0], q1.shape[1]
    nblk = S // Q_BLOCK
    scale = DIFF_QK_DIM ** -0.5
    k_pos = jnp.arange(S)

    def to_blocks(t):
        return t.reshape(B, nblk, Q_BLOCK, N_DIFF_HEADS, DIFF_QK_DIM).transpose(1, 0, 2, 3, 4)

    def one_block(args):
        q1b, q2b, i = args
        q_pos = i * Q_BLOCK + jnp.arange(Q_BLOCK)
        bias = rel_bias.astype(jnp.float32)[t5_bucket(q_pos, k_pos)]
        bias = bias.transpose(2, 0, 1)[None]
        mask = (k_pos[None, :] <= q_pos[:, None])[None, None]
        s1 = jnp.einsum('bqhd,bkhd->bhqk', q1b, k1).astype(jnp.float32) * scale + bias
        s2 = jnp.einsum('bqhd,bkhd->bhqk', q2b, k2).astype(jnp.float32) * scale + bias
        p1 = jax.nn.softmax(jnp.where(mask, s1, -1e30), axis=-1)
        p2 = jax.nn.softmax(jnp.where(mask, s2, -1e30), axis=-1)
        attn = (p1 - lam * p2).astype(v.dtype)
        return jnp.einsum('bhqk,bkhd->bqhd', attn, v)

    out = lax.map(one_block, (to_blocks(q1), to_blocks(q2), jnp.arange(nblk)))
    out = out.transpose(1, 0, 2, 3, 4).reshape(B, S, N_DIFF_HEADS, DIFF_V_DIM)
    out = rms_norm(out, norm_g) * (1.0 - lam_init)
    return out.reshape(B, S, N_DIFF_HEADS * DIFF_V_DIM)


def spatial_gating(u, v, ln_g, ln_b, sg_w, sg_b):
    B, S = u.shape[0], u.shape[1]
    nc = S // CHUNK
    u = jax.nn.gelu(u)
    v = layer_norm(jax.nn.gelu(v), ln_g, ln_b)
    vc = v.reshape(B, nc, CHUNK, N_SG_HEADS, SG_HEAD_DIM)
    w = sg_w * jnp.tril(jnp.ones((CHUNK, CHUNK), sg_w.dtype))
    mixed = jnp.einsum('hts,bcshd->bcthd', w, vc) + sg_b.T[None, None, :, :, None]
    return u * mixed.reshape(B, S, D_GROUP)


def multiscale_pool(p, pool_w, pool_scale):
    B, S = p.shape[0], p.shape[1]
    pg = p.reshape(B, S, N_POOL_GROUPS, POOL_GROUP_DIM)
    cs = jnp.cumsum(pg.astype(jnp.float32), axis=1)
    t = jnp.arange(S)
    outs = []
    for g, w in enumerate(POOL_WINDOWS):
        c = cs[:, :, g]
        lag = jnp.pad(c, ((0, 0), (w, 0), (0, 0)))[:, :S]
        cnt = jnp.minimum(t + 1, w).astype(jnp.float32)[None, :, None]
        outs.append((c - lag) / cnt)
    pooled = jnp.stack(outs, axis=2).astype(p.dtype) - pg
    mixed = jnp.einsum('bsgc,gcd->bsgd', pooled, pool_w)
    return mixed.reshape(B, S, D_GROUP) * pool_scale


def setup_inputs(seed: int = 0) -> dict:
    key = jax.random.key(seed)
    ks = jax.random.split(key, 32)
    f32 = jnp.float32
    L = DEPTH

    def nrm(k, shape, scale):
        return jax.random.normal(k, shape, f32) * scale

    return {
        "x": jax.random.normal(ks[0], (BATCH, SEQ, D_MODEL), f32),
        "emb_ln_g": 1.0 + nrm(ks[1], (D_MODEL,), 0.05),
        "emb_ln_b": nrm(ks[2], (D_MODEL,), 0.02),
        "rel_bias": nrm(ks[3], (N_BUCKETS, N_DIFF_HEADS), 0.5),
        "w_in": nrm(ks[4], (L, D_MODEL, D_IN), D_MODEL ** -0.5),
        "conv_w": nrm(ks[5], (L, CONV_WIDTH, D_GROUP), CONV_WIDTH ** -0.5),
        "conv_b": nrm(ks[6], (L, D_GROUP), 0.02),
        "conv_ln_g": 1.0 + nrm(ks[7], (L, D_GROUP), 0.05),
        "conv_ln_b": nrm(ks[8], (L, D_GROUP), 0.02),
        "conv_pw_w": nrm(ks[9], (L, D_GROUP, D_GROUP), D_GROUP ** -0.5),
        "conv_pw_b": nrm(ks[10], (L, D_GROUP), 0.02),
        "lam_q1": nrm(ks[11], (L, DIFF_QK_DIM), 0.1),
        "lam_k1": nrm(ks[12], (L, DIFF_QK_DIM), 0.1),
        "lam_q2": nrm(ks[13], (L, DIFF_QK_DIM), 0.1),
        "lam_k2": nrm(ks[14], (L, DIFF_QK_DIM), 0.1),
        "diff_norm_g": 1.0 + nrm(ks[15], (L, DIFF_V_DIM), 0.05),
        "sg_ln_g": 1.0 + nrm(ks[16], (L, D_GROUP), 0.05),
        "sg_ln_b": nrm(ks[17], (L, D_GROUP), 0.02),
        "sg_w": nrm(ks[18], (L, N_SG_HEADS, CHUNK, CHUNK), 0.5 * CHUNK ** -0.5),
        "sg_b": 1.0 + nrm(ks[19], (L, N_SG_HEADS, CHUNK), 0.1),
        "pool_w": nrm(ks[20], (L, N_POOL_GROUPS, POOL_GROUP_DIM, POOL_GROUP_DIM), POOL_GROUP_DIM ** -0.5),
        "pool_scale": 1.0 + nrm(ks[21], (L, D_GROUP), 0.1),
        "w_out": nrm(ks[22], (L, D_MIX, D_MODEL), DEEPNORM_BETA * D_MIX ** -0.5),
        "ln1_g": 1.0 + nrm(ks[23], (L, D_MODEL), 0.05),
        "ln1_b": nrm(ks[24], (L, D_MODEL), 0.02),
        "w_mlp1": nrm(ks[25], (L, D_MODEL, D_FF), D_MODEL ** -0.5),
        "w_mlp2": nrm(ks[26], (L, D_FF, D_MODEL), DEEPNORM_BETA * D_FF ** -0.5),
        "ln2_g": 1.0 + nrm(ks[27], (L, D_MODEL), 0.05),
        "ln2_b": nrm(ks[28], (L, D_MODEL), 0.02),
    }


def reference(x, emb_ln_g, emb_ln_b, rel_bias, w_in, conv_w, conv_b, conv_ln_g, conv_ln_b,
              conv_pw_w, conv_pw_b, lam_q1, lam_k1, lam_q2, lam_k2, diff_norm_g,
              sg_ln_g, sg_ln_b, sg_w, sg_b, pool_w, pool_scale, w_out,
              ln1_g, ln1_b, w_mlp1, w_mlp2, ln2_g, ln2_b):
    B, S, _ = x.shape
    o = SPLIT_OFFSETS
    h = layer_norm(x, emb_ln_g, emb_ln_b)
    for l in range(DEPTH):
        z = h @ w_in[l]
        za, zq1, zq2, zk1, zk2, zv, zu, zsv, zp = [z[..., o[i]:o[i + 1]] for i in range(len(SPLIT_SIZES))]

        y_conv = conformer_conv(za[..., :D_GROUP], za[..., D_GROUP:], conv_w[l], conv_b[l],
                                conv_ln_g[l], conv_ln_b[l], conv_pw_w[l], conv_pw_b[l])

        lam_init = 0.8 - 0.6 * math.exp(-0.3 * l)
        lam = (jnp.exp(jnp.sum(lam_q1[l].astype(jnp.float32) * lam_k1[l].astype(jnp.float32)))
               - jnp.exp(jnp.sum(lam_q2[l].astype(jnp.float32) * lam_k2[l].astype(jnp.float32)))
               + lam_init)
        qk_shape = (B, S, N_DIFF_HEADS, DIFF_QK_DIM)
        y_diff = diff_attention(zq1.reshape(qk_shape), zq2.reshape(qk_shape),
                                zk1.reshape(qk_shape), zk2.reshape(qk_shape),
                                zv.reshape(B, S, N_DIFF_HEADS, DIFF_V_DIM),
                                lam, lam_init, rel_bias, diff_norm_g[l])

        y_sg = spatial_gating(zu, zsv, sg_ln_g[l], sg_ln_b[l], sg_w[l], sg_b[l])

        y_pool = multiscale_pool(zp, pool_w[l], pool_scale[l])

        mix = jnp.concatenate([y_conv, y_diff, y_sg, y_pool], axis=-1) @ w_out[l]
        h = layer_norm(DEEPNORM_ALPHA * h + mix, ln1_g[l], ln1_b[l])

        ff = jnp.square(jax.nn.relu(h @ w_mlp1[l])) @ w_mlp2[l]
        h = layer_norm(DEEPNORM_ALPHA * h + ff, ln2_g[l], ln2_b[l])
    return h
```

```cpp
#include <hip/hip_runtime.h>
#include <stdint.h>
#include <cstdio>

typedef unsigned short bf16_t;
typedef short bf16x8 __attribute__((ext_vector_type(8)));
typedef float f32x4 __attribute__((ext_vector_type(4)));

constexpr int BATCH = 4, SEQ = 4096, DM = 1024, DEPTH = 2;
constexpr int M = BATCH * SEQ;
constexpr int DG = 256, DIN = 2048, DFF = 4096;
constexpr int NH = 4, DQK = 32, DV = 64, CHUNK = 128, CONVW = 31;
constexpr float LN_EPS = 1e-5f;
constexpr float ALPHA = 1.41421356237309515f;
constexpr float LOG2E = 1.44269504088896341f;
constexpr float QSCALE = 0.17677669529663687f * LOG2E;
constexpr int ZC_A = 0, ZC_G = 256, ZC_Q1 = 512, ZC_Q2 = 640, ZC_K1 = 768, ZC_K2 = 896, ZC_V = 1024, ZC_U = 1280, ZC_SV = 1536, ZC_P = 1792;

constexpr size_t MiB = 1u << 20;
constexpr size_t WS_CTL = 0;
constexpr size_t WS_SMALL = 1 * MiB;
constexpr size_t WS_W = 2 * MiB;
constexpr size_t WL_IN = 0, WL_OUT = 4 * MiB, WL_W1 = 6 * MiB, WL_W2 = 14 * MiB, WL_PW = 22 * MiB, WL_POOL = 22 * MiB + 128 * 1024, WL_SG = 22 * MiB + 256 * 1024, WL_STRIDE = 23 * MiB;
constexpr size_t WS_HBF = 48 * MiB;
constexpr size_t WS_BIG = 80 * MiB;
constexpr size_t WS_Z = WS_BIG, WS_MIX = WS_BIG + 64 * MiB, WS_T1 = WS_BIG + 96 * MiB, WS_T2 = WS_BIG + 112 * MiB;
constexpr size_t WS_T3 = 208 * MiB;
constexpr size_t WS_END = 256 * MiB;

__device__ __forceinline__ float bf2f(bf16_t v) { return __uint_as_float(((unsigned)v) << 16); }
__device__ __forceinline__ bf16_t f2bf(float f) { unsigned u = __float_as_uint(f); return (bf16_t)((u + 0x7fffu + ((u >> 16) & 1u)) >> 16); }
__device__ __forceinline__ float sigmoidf_(float x) { return 1.0f / (1.0f + __expf(-x)); }
__device__ __forceinline__ float gelu_tanh(float x) { const float u = 0.7978845608028654f * (x + 0.044715f * x * x * x); return 0.5f * x * (1.0f + tanhf(u)); }
__device__ __forceinline__ float wave_sum(float v) {
#pragma unroll
    for (int o = 1; o < 64; o <<= 1) v += __shfl_xor(v, o);
    return v;
}

__constant__ unsigned char c_bucket[128] = {0, 1, 2, 3, 4, 5, 6, 7, 8, 9, 10, 11, 12, 13, 14, 15, 16, 16, 16, 17, 17, 18, 18, 18, 19, 19, 19, 20, 20, 20, 20, 21, 21, 21, 21, 22, 22, 22, 22, 22, 23, 23, 23, 23, 23, 23, 24, 24, 24, 24, 24, 24, 25, 25, 25, 25, 25, 25, 25, 26, 26, 26, 26, 26, 26, 26, 26, 27, 27, 27, 27, 27, 27, 27, 27, 27, 27, 28, 28, 28, 28, 28, 28, 28, 28, 28, 28, 29, 29, 29, 29, 29, 29, 29, 29, 29, 29, 29, 29, 30, 30, 30, 30, 30, 30, 30, 30, 30, 30, 30, 30, 30, 30, 31, 31, 31, 31, 31, 31, 31, 31, 31, 31, 31, 31, 31, 31, 31};

__global__ void nk_setup(const float* rel_bias, const float* lq1, const float* lk1, const float* lq2, const float* lk2, float* small) {
    const int t = threadIdx.x;
    if (t < DEPTH) {
        float s1 = 0.f, s2 = 0.f;
        for (int i = 0; i < DQK; ++i) { s1 += lq1[t * DQK + i] * lk1[t * DQK + i]; s2 += lq2[t * DQK + i] * lk2[t * DQK + i]; }
        const float lam_init = 0.8f - 0.6f * expf(-0.3f * (float)t);
        small[t] = expf(s1) - expf(s2) + lam_init;
        small[2 + t] = lam_init;
    }
    for (int i = t; i < NH * 128; i += blockDim.x) { const int h = i / 128, n = i % 128; small[16 + i] = rel_bias[c_bucket[n] * NH + h] * LOG2E; }
}
__global__ void nk_transpose(const float* W, int K, int N, bf16_t* WT, int mode) {
    const size_t idx = (size_t)blockIdx.x * 256 + threadIdx.x;
    if (idx >= (size_t)K * N) return;
    if (mode == 0) { const int n = (int)(idx / K), k = (int)(idx % K); WT[idx] = f2bf(W[(size_t)k * N + n]); }
    else { const int r = (int)(idx / N), c = (int)(idx % N); WT[idx] = f2bf(c <= r ? W[idx] : 0.f); }
}
__global__ __launch_bounds__(256) void nk_ln(const float* in, const float* g, const float* b, float* outf, bf16_t* outb) {
    const int row = blockIdx.x * 4 + (threadIdx.x >> 6), lane = threadIdx.x & 63;
    const f32x4* xr = (const f32x4*)(in + (size_t)row * DM) + lane;
    f32x4 v[4]; float s = 0.f;
#pragma unroll
    for (int j = 0; j < 4; ++j) { v[j] = xr[64 * j]; s += (v[j].x + v[j].y) + (v[j].z + v[j].w); }
    const float mean = wave_sum(s) * (1.f / DM); float s2 = 0.f;
#pragma unroll
    for (int j = 0; j < 4; ++j) { v[j] = v[j] - mean; s2 += (v[j].x * v[j].x + v[j].y * v[j].y) + (v[j].z * v[j].z + v[j].w * v[j].w); }
    const float rstd = rsqrtf(wave_sum(s2) * (1.f / DM) + LN_EPS);
#pragma unroll
    for (int j = 0; j < 4; ++j) {
        const int c = (lane + 64 * j) * 4;
        const f32x4 gg = *(const f32x4*)(g + c), bb = *(const f32x4*)(b + c);
        const f32x4 o = v[j] * rstd * gg + bb;
        if (outf) *((f32x4*)(outf + (size_t)row * DM + c)) = o;
        if (outb) { bf16_t* p = outb + (size_t)row * DM + c; p[0] = f2bf(o.x); p[1] = f2bf(o.y); p[2] = f2bf(o.z); p[3] = f2bf(o.w); }
    }
}
template <int EPI>
__global__ __launch_bounds__(256) void nk_gemm(const bf16_t* A, int lda, const bf16_t* Bt, int ldb, int K, void* out, int ldc, const float* bias, float alpha, int sc0, int sc1, float cscale) {
    const int wave = threadIdx.x >> 6, lane = threadIdx.x & 63, fr = lane & 15, fq = lane >> 4;
    const int row0 = blockIdx.y * 128 + (wave >> 1) * 64, col0 = blockIdx.x * 128 + (wave & 1) * 64;
    f32x4 acc[4][4];
#pragma unroll
    for (int i = 0; i < 4; ++i)
#pragma unroll
        for (int j = 0; j < 4; ++j) acc[i][j] = (f32x4){0.f, 0.f, 0.f, 0.f};
    for (int k0 = 0; k0 < K; k0 += 32) {
        bf16x8 a[4], b[4];
#pragma unroll
        for (int i = 0; i < 4; ++i) a[i] = *(const bf16x8*)(A + (size_t)(row0 + i * 16 + fr) * lda + k0 + fq * 8);
#pragma unroll
        for (int j = 0; j < 4; ++j) b[j] = *(const bf16x8*)(Bt + (size_t)(col0 + j * 16 + fr) * ldb + k0 + fq * 8);
#pragma unroll
        for (int i = 0; i < 4; ++i)
#pragma unroll
            for (int j = 0; j < 4; ++j) acc[i][j] = __builtin_amdgcn_mfma_f32_16x16x32_bf16(a[i], b[j], acc[i][j], 0, 0, 0);
    }
#pragma unroll
    for (int i = 0; i < 4; ++i)
#pragma unroll
        for (int j = 0; j < 4; ++j)
#pragma unroll
            for (int r = 0; r < 4; ++r) {
                const int row = row0 + i * 16 + fq * 4 + r, col = col0 + j * 16 + fr;
                float v = acc[i][j][r];
                if (bias) v += bias[col];
                if (EPI == 0) { if (col >= sc0 && col < sc1) v *= cscale; ((bf16_t*)out)[(size_t)row * ldc + col] = f2bf(v); }
                else if (EPI == 1) { v = v > 0.f ? v * v : 0.f; ((bf16_t*)out)[(size_t)row * ldc + col] = f2bf(v); }
                else { float* o = (float*)out + (size_t)row * ldc + col; *o = alpha * (*o) + v; }
            }
}
__global__ void nk_conv_a(const bf16_t* z, const float* cw, const float* cb, float* T1) {
    const int idx = blockIdx.x * 256 + threadIdx.x; const int m = idx >> 8, c = idx & 255, t = m % SEQ;
    float acc = cb[c];
    for (int j = 0; j < CONVW; ++j) { const int tt = t - (CONVW - 1) + j; if (tt < 0) continue;
        const bf16_t* zr = z + (size_t)(m - (CONVW - 1) + j) * DIN; const float a = bf2f(zr[ZC_A + c]), g = bf2f(zr[ZC_G + c]);
        acc += a * sigmoidf_(g) * cw[j * DG + c]; }
    T1[idx] = acc;
}
template <int MODE>
__global__ __launch_bounds__(256) void nk_ln256(const float* inT, const bf16_t* z, const float* g, const float* b, float* outf, bf16_t* outb) {
    const int row = blockIdx.x * 4 + (threadIdx.x >> 6), lane = threadIdx.x & 63;
    float v[4]; float s = 0.f;
#pragma unroll
    for (int j = 0; j < 4; ++j) { const int c = lane + 64 * j; v[j] = MODE == 0 ? inT[(size_t)row * DG + c] : gelu_tanh(bf2f(z[(size_t)row * DIN + ZC_SV + c])); s += v[j]; }
    const float mean = wave_sum(s) * (1.f / DG); float s2 = 0.f;
#pragma unroll
    for (int j = 0; j < 4; ++j) { v[j] -= mean; s2 += v[j] * v[j]; }
    const float rstd = rsqrtf(wave_sum(s2) * (1.f / DG) + LN_EPS);
#pragma unroll
    for (int j = 0; j < 4; ++j) { const int c = lane + 64 * j; const float o = v[j] * rstd * g[c] + b[c];
        if (MODE == 0) outb[(size_t)row * DG + c] = f2bf(o * sigmoidf_(o)); else outf[(size_t)row * DG + c] = o; }
}
__global__ __launch_bounds__(256) void nk_attn(const bf16_t* z, const float* small, float* T3) {
    const int idx = blockIdx.x * 256 + threadIdx.x; const int q = idx % SEQ, bh = (idx / SEQ) % (BATCH * NH), map = idx / (SEQ * BATCH * NH), b = bh / NH, h = bh % NH;
    const bf16_t* zb = z + (size_t)b * SEQ * DIN;
    const float* bt = small + 16 + h * 128;
    float qv[DQK];
#pragma unroll
    for (int d = 0; d < DQK; ++d) qv[d] = bf2f(zb[(size_t)q * DIN + ZC_Q1 + map * 128 + h * DQK + d]);
    const int kend = __builtin_amdgcn_readfirstlane(q | 63);
    const int kc = ZC_K1 + map * 128 + h * DQK, vc = ZC_V + h * DV;
    float mx = -3.0e38f;
    for (int k = 0; k <= kend; ++k) {
        const bf16_t* kr = zb + (size_t)k * DIN + kc; float s = 0.f;
#pragma unroll
        for (int d = 0; d < DQK; ++d) s += qv[d] * bf2f(kr[d]);
        const int n = q - k; s += bt[n < 127 ? (n < 0 ? 0 : n) : 127];
        if (k <= q) mx = fmaxf(mx, s);
    }
    float l = 0.f; float o[DV];
#pragma unroll
    for (int d = 0; d < DV; ++d) o[d] = 0.f;
    for (int k = 0; k <= kend; ++k) {
        const bf16_t* kr = zb + (size_t)k * DIN + kc; float s = 0.f;
#pragma unroll
        for (int d = 0; d < DQK; ++d) s += qv[d] * bf2f(kr[d]);
        const int n = q - k; s += bt[n < 127 ? (n < 0 ? 0 : n) : 127];
        const float p = (k <= q) ? exp2f(s - mx) : 0.f;
        l += p;
        const bf16_t* vr = zb + (size_t)k * DIN + vc;
#pragma unroll
        for (int d = 0; d < DV; ++d) o[d] += p * bf2f(vr[d]);
    }
    const float il = 1.f / l;
    float* op = T3 + ((size_t)map * M + (size_t)b * SEQ + q) * DG + h * DV;
#pragma unroll
    for (int d = 0; d < DV; ++d) op[d] = o[d] * il;
}
__global__ void nk_attn_comb(const float* T3, const float* small, int layer, const float* ng, bf16_t* mix) {
    const int idx = blockIdx.x * 256 + threadIdx.x; const int m = idx / NH, h = idx % NH;
    const float lam = small[layer], li = small[2 + layer];
    const float* o1 = T3 + (size_t)m * DG + h * DV; const float* o2 = T3 + ((size_t)M + m) * DG + h * DV;
    float ss = 0.f;
    for (int d = 0; d < DV; ++d) { const float x = o1[d] - lam * o2[d]; ss += x * x; }
    const float r = rsqrtf(ss * (1.f / DV) + LN_EPS) * (1.f - li);
    for (int d = 0; d < DV; ++d) { const float x = o1[d] - lam * o2[d]; mix[(size_t)m * DM + 256 + h * DV + d] = f2bf(x * r * ng[d]); }
}
__global__ void nk_sg_b(const bf16_t* z, const float* T1, const float* sgw, const float* sgb, bf16_t* mix) {
    const int idx = blockIdx.x * 256 + threadIdx.x; const int m = idx >> 8, c = idx & 255, h = c >> 6, t = m % CHUNK, m0 = m - t;
    float acc = sgb[h * CHUNK + t];
    const float* wr = sgw + ((size_t)h * CHUNK + t) * CHUNK;
    for (int s = 0; s <= t; ++s) acc += wr[s] * T1[(size_t)(m0 + s) * DG + c];
    const float u = gelu_tanh(bf2f(z[(size_t)m * DIN + ZC_U + c]));
    mix[(size_t)m * DM + 512 + c] = f2bf(u * acc);
}
__global__ void nk_pool_a(const bf16_t* z, float* T1) {
    const int idx = blockIdx.x * 256 + threadIdx.x; const int m = idx >> 8, c = idx & 255, g = c >> 6, w = 2 << g, t = m % SEQ;
    const int cnt = (t + 1 < w) ? t + 1 : w; float s = 0.f;
    for (int j = 0; j < cnt; ++j) s += bf2f(z[(size_t)(m - j) * DIN + ZC_P + c]);
    T1[idx] = s / (float)cnt - bf2f(z[(size_t)m * DIN + ZC_P + c]);
}
__global__ void nk_pool_b(const float* T1, const float* pw, const float* ps, bf16_t* mix) {
    const int idx = blockIdx.x * 256 + threadIdx.x; const int m = idx >> 8, c = idx & 255, g = c >> 6, d = c & 63;
    float acc = 0.f;
    for (int cc = 0; cc < 64; ++cc) acc += T1[(size_t)m * DG + g * 64 + cc] * pw[((size_t)g * 64 + cc) * 64 + d];
    mix[(size_t)m * DM + 768 + c] = f2bf(acc * ps[c]);
}

extern "C" void kernel_launch(void* const* d_in, const int* in_sizes, int n_in, void* d_out, int out_size, void* d_ws, size_t ws_size, hipStream_t stream) {
    if (n_in != 29 || out_size != M * DM || ws_size < WS_END) { fprintf(stderr, "kernel_launch: unexpected shapes n_in %d out %d ws %zu\n", n_in, out_size, ws_size); return; }
    const float* x = (const float*)d_in[0];
    const float* emb_g = (const float*)d_in[1]; const float* emb_b = (const float*)d_in[2];
    const float* rel_bias = (const float*)d_in[3];
    const float* w_in = (const float*)d_in[4]; const float* conv_w = (const float*)d_in[5]; const float* conv_b = (const float*)d_in[6];
    const float* conv_ln_g = (const float*)d_in[7]; const float* conv_ln_b = (const float*)d_in[8];
    const float* conv_pw_w = (const float*)d_in[9]; const float* conv_pw_b = (const float*)d_in[10];
    const float* lq1 = (const float*)d_in[11]; const float* lk1 = (const float*)d_in[12]; const float* lq2 = (const float*)d_in[13]; const float* lk2 = (const float*)d_in[14];
    const float* diff_g = (const float*)d_in[15]; const float* sg_ln_g = (const float*)d_in[16]; const float* sg_ln_b = (const float*)d_in[17];
    const float* sg_w = (const float*)d_in[18]; const float* sg_b = (const float*)d_in[19]; const float* pool_w = (const float*)d_in[20]; const float* pool_s = (const float*)d_in[21];
    const float* w_out = (const float*)d_in[22]; const float* ln1_g = (const float*)d_in[23]; const float* ln1_b = (const float*)d_in[24];
    const float* w1 = (const float*)d_in[25]; const float* w2 = (const float*)d_in[26]; const float* ln2_g = (const float*)d_in[27]; const float* ln2_b = (const float*)d_in[28];
    unsigned char* ws = (unsigned char*)d_ws;
    float* hf = (float*)d_out;
    float* small = (float*)(ws + WS_SMALL);
    bf16_t* hbf = (bf16_t*)(ws + WS_HBF); bf16_t* zb = (bf16_t*)(ws + WS_Z); bf16_t* mix = (bf16_t*)(ws + WS_MIX); bf16_t* hid = (bf16_t*)(ws + WS_BIG);
    float* T1 = (float*)(ws + WS_T1); bf16_t* T2 = (bf16_t*)(ws + WS_T2); float* T3 = (float*)(ws + WS_T3);

    nk_setup<<<1, 256, 0, stream>>>(rel_bias, lq1, lk1, lq2, lk2, small);
    for (int l = 0; l < DEPTH; ++l) {
        unsigned char* wl = ws + WS_W + l * WL_STRIDE;
        nk_transpose<<<DM * DIN / 256, 256, 0, stream>>>(w_in + (size_t)l * DM * DIN, DM, DIN, (bf16_t*)(wl + WL_IN), 0);
        nk_transpose<<<DM * DM / 256, 256, 0, stream>>>(w_out + (size_t)l * DM * DM, DM, DM, (bf16_t*)(wl + WL_OUT), 0);
        nk_transpose<<<DM * DFF / 256, 256, 0, stream>>>(w1 + (size_t)l * DM * DFF, DM, DFF, (bf16_t*)(wl + WL_W1), 0);
        nk_transpose<<<DM * DFF / 256, 256, 0, stream>>>(w2 + (size_t)l * DM * DFF, DFF, DM, (bf16_t*)(wl + WL_W2), 0);
        nk_transpose<<<DG * DG / 256, 256, 0, stream>>>(conv_pw_w + (size_t)l * DG * DG, DG, DG, (bf16_t*)(wl + WL_PW), 0);
    }
    nk_ln<<<M / 4, 256, 0, stream>>>(x, emb_g, emb_b, hf, hbf);
    for (int l = 0; l < DEPTH; ++l) {
        unsigned char* wl = ws + WS_W + l * WL_STRIDE;
        nk_gemm<0><<<dim3(DIN / 128, M / 128), 256, 0, stream>>>(hbf, DM, (const bf16_t*)(wl + WL_IN), DM, DM, zb, DIN, nullptr, 0.f, ZC_Q1, ZC_K1, QSCALE);
        nk_conv_a<<<M * DG / 256, 256, 0, stream>>>(zb, conv_w + (size_t)l * CONVW * DG, conv_b + l * DG, T1);
        nk_ln256<0><<<M / 4, 256, 0, stream>>>(T1, zb, conv_ln_g + l * DG, conv_ln_b + l * DG, nullptr, T2);
        nk_gemm<0><<<dim3(DG / 128, M / 128), 256, 0, stream>>>(T2, DG, (const bf16_t*)(wl + WL_PW), DG, DG, mix, DM, conv_pw_b + l * DG, 0.f, 0, 0, 1.f);
        nk_attn<<<2 * BATCH * NH * SEQ / 256, 256, 0, stream>>>(zb, small, T3);
        nk_attn_comb<<<M * NH / 256, 256, 0, stream>>>(T3, small, l, diff_g + l * DV, mix);
        nk_ln256<1><<<M / 4, 256, 0, stream>>>(nullptr, zb, sg_ln_g + l * DG, sg_ln_b + l * DG, T1, nullptr);
        nk_sg_b<<<M * DG / 256, 256, 0, stream>>>(zb, T1, sg_w + (size_t)l * NH * CHUNK * CHUNK, sg_b + l * NH * CHUNK, mix);
        nk_pool_a<<<M * DG / 256, 256, 0, stream>>>(zb, T1);
        nk_pool_b<<<M * DG / 256, 256, 0, stream>>>(T1, pool_w + (size_t)l * 4 * 64 * 64, pool_s + l * DG, mix);
        nk_gemm<2><<<dim3(DM / 128, M / 128), 256, 0, stream>>>(mix, DM, (const bf16_t*)(wl + WL_OUT), DM, DM, hf, DM, nullptr, ALPHA, 0, 0, 1.f);
        nk_ln<<<M / 4, 256, 0, stream>>>(hf, ln1_g + l * DM, ln1_b + l * DM, hf, hbf);
        nk_gemm<1><<<dim3(DFF / 128, M / 128), 256, 0, stream>>>(hbf, DM, (const bf16_t*)(wl + WL_W1), DM, DM, hid, DFF, nullptr, 0.f, 0, 0, 1.f);
        nk_gemm<2><<<dim3(DM / 128, M / 128), 256, 0, stream>>>(hid, DFF, (const bf16_t*)(wl + WL_W2), DFF, DFF, hf, DM, nullptr, ALPHA, 0, 0, 1.f);
        nk_ln<<<M / 4, 256, 0, stream>>>(hf, ln2_g + l * DM, ln2_b + l * DM, hf, hbf);
    }
}
```
